# Optimizing an MI355X kernel written in HIP

```python
import math
import jax, jax.numpy as jnp
from jax import lax
import numpy as np

D_MODEL = 1024
BATCH = 8
SEQ = 2048
DEPTH = 4

N_A_LAYERS = DEPTH // 2
N_B_LAYERS = DEPTH - N_A_LAYERS
MIX_W = D_MODEL
MEM_LEN = 256
MEM_HEADS = 4
MEM_HEAD_DIM = 64
MEM_W = MEM_HEADS * MEM_HEAD_DIM
SEQ_MIX_W = MIX_W - MEM_W
HGRN_EXPAND = 128
HGRN_HEADS = SEQ_MIX_W // HGRN_EXPAND
HGRN_DK = HGRN_EXPAND
HGRN_DV = SEQ_MIX_W // HGRN_HEADS
HGRN_CHUNK = 64
SB_HEAD_DIM = 64
SB_HEADS = SEQ_MIX_W // SB_HEAD_DIM
SB_BLOCK = 128
A_IN_W = 4 * SEQ_MIX_W + MEM_W
B_IN_W = SEQ_MIX_W + MEM_W
N_GROUPS = 4
EXPERTS_PER_GROUP = 4
N_EXPERTS = N_GROUPS * EXPERTS_PER_GROUP
TOP_K_IN_GROUP = 2
D_EXPERT = 256
DEEPNORM_ALPHA = (2 * DEPTH) ** 0.25
DEEPNORM_BETA = (8 * DEPTH) ** -0.25
LN_EPS = 1e-5
RMS_EPS = 1e-6

kernel_name = "yoco_hgrn2_stickbreaking_hmoe_deepnorm"


def layer_norm(x, g, b):
    xf = x.astype(jnp.float32)
    mu = jnp.mean(xf, axis=-1, keepdims=True)
    var = jnp.mean(jnp.square(xf - mu), axis=-1, keepdims=True)
    y = (xf - mu) * lax.rsqrt(var + LN_EPS) * g.astype(jnp.float32) + b.astype(jnp.float32)
    return y.astype(x.dtype)


def post_norm(x, y, g, b):
    return layer_norm(DEEPNORM_ALPHA * x + y.astype(x.dtype), g, b)


def gla_chunkwise(q, k, v, logf):
    B, S, H, dk = q.shape
    dv = v.shape[-1]
    nc = S // HGRN_CHUNK

    def to_chunks(t):
        return t.reshape(B, nc, HGRN_CHUNK, H, t.shape[-1]).transpose(1, 0, 3, 2, 4)

    qc, kc, vc = to_chunks(q), to_chunks(k), to_chunks(v)
    G = jnp.cumsum(to_chunks(logf), axis=3)
    incl = jnp.tril(jnp.ones((HGRN_CHUNK, HGRN_CHUNK), dtype=bool))

    def step(state, inp):
        q_, k_, v_, G_ = inp
        diff = G_[:, :, :, None, :] - G_[:, :, None, :, :]
        decay = jnp.exp(jnp.where(incl[:, :, None], diff, -jnp.inf))
        scores = jnp.einsum('bhtd,bhsd,bhtsd->bhts', q_, k_, decay)
        out = (jnp.einsum('bhts,bhse->bhte', scores, v_)
               + jnp.einsum('bhtd,bhde->bhte', q_ * jnp.exp(G_), state))
        g_last = G_[:, :, -1]
        state = (jnp.exp(g_last)[..., None] * state
                 + jnp.einsum('bhsd,bhse->bhde', k_ * jnp.exp(g_last[:, :, None] - G_), v_))
        return state, out

    s0 = jnp.zeros((B, H, dk, dv), jnp.float32)
    _, out = lax.scan(step, s0, (qc, kc, vc, G))
    return out.transpose(1, 0, 3, 2, 4).reshape(B, S, H, dv)


def hgrn2_mix(q, f_raw, i_in, g, lb, gnorm):
    B, S, _ = q.shape
    qh = (jax.nn.silu(q.astype(jnp.float32)) * HGRN_DK ** -0.5).reshape(B, S, HGRN_HEADS, HGRN_DK)
    lbf = lb.astype(jnp.float32)
    logf = jnp.logaddexp(jnp.log(lbf), jnp.log1p(-lbf) + jax.nn.log_sigmoid(f_raw.astype(jnp.float32)))
    logf = logf.reshape(B, S, HGRN_HEADS, HGRN_DK)
    kh = -jnp.expm1(logf)
    vh = i_in.astype(jnp.float32).reshape(B, S, HGRN_HEADS, HGRN_DV)
    o = gla_chunkwise(qh, kh, vh, logf)
    o = o * lax.rsqrt(jnp.mean(jnp.square(o), axis=-1, keepdims=True) + RMS_EPS)
    o = o * gnorm.astype(jnp.float32).reshape(HGRN_HEADS, HGRN_DV)
    o = o.reshape(B, S, SEQ_MIX_W) * jax.nn.silu(g.astype(jnp.float32))
    return o


def stick_breaking_attention(q, k, v):
    B, S, _ = q.shape
    qh = q.astype(jnp.float32).reshape(B, S, SB_HEADS, SB_HEAD_DIM).transpose(0, 2, 1, 3)
    scale = 1.0 / math.sqrt(SB_HEAD_DIM)
    outs = []
    for blk in range(S // SB_BLOCK):
        start, end = blk * SB_BLOCK, (blk + 1) * SB_BLOCK
        qb = qh[:, :, start:end]
        kb, vb = k[:, :, :end], v[:, :, :end]
        z = jnp.einsum('bhtd,bhsd->bhts', qb, kb) * scale
        t_pos = start + jnp.arange(SB_BLOCK)
        s_pos = jnp.arange(end)
        mask = s_pos[None, :] < t_pos[:, None]
        neg_log_1m_beta = jnp.where(mask, jax.nn.softplus(z), 0.0)
        rest = lax.cumsum(neg_log_1m_beta, axis=3, reverse=True) - neg_log_1m_beta
        log_a = jax.nn.log_sigmoid(z) - rest
        a = jnp.where(mask, jnp.exp(log_a), 0.0)
        outs.append(jnp.einsum('bhts,bhsd->bhtd', a, vb))
    o = jnp.concatenate(outs, axis=2)
    return o.transpose(0, 2, 1, 3).reshape(B, S, SEQ_MIX_W)


def memory_attention(qm, mem_k, mem_v):
    B, S, _ = qm.shape
    qh = qm.astype(jnp.float32).reshape(B, S, MEM_HEADS, MEM_HEAD_DIM)
    scores = jnp.einsum('bthd,bmhd->bhtm', qh, mem_k.astype(jnp.float32)) / math.sqrt(MEM_HEAD_DIM)
    p = jax.nn.softmax(scores, axis=-1)
    o = jnp.einsum('bhtm,bmhd->bthd', p, mem_v.astype(jnp.float32))
    return o.reshape(B, S, MEM_W)


def hier_moe(x, w_group, b_group, w_router, b_router, w_gate, w_up, w_down):
    B, S, D = x.shape
    xf = x.reshape(B * S, D)
    T = xf.shape[0]
    probs_g = jax.nn.softmax((xf @ w_group + b_group).astype(jnp.float32), axis=-1)
    p_top, g_idx = lax.top_k(probs_g, 1)
    logits_e = (xf @ w_router + b_router).astype(jnp.float32).reshape(T, N_GROUPS, EXPERTS_PER_GROUP)
    in_group = jnp.take_along_axis(logits_e, g_idx[:, :, None], axis=1)[:, 0]
    probs_in = jax.nn.softmax(in_group, axis=-1)
    w_top, e_local = lax.top_k(probs_in, TOP_K_IN_GROUP)
    w_top = w_top / jnp.sum(w_top, axis=-1, keepdims=True)
    ids = g_idx * EXPERTS_PER_GROUP + e_local
    gates = jnp.einsum('tk,tke->te', p_top * w_top, jax.nn.one_hot(ids, N_EXPERTS, dtype=jnp.float32))
    h = jax.nn.silu(jnp.einsum('td,edf->tef', xf, w_gate)) * jnp.einsum('td,edf->tef', xf, w_up)
    y = jnp.einsum('tef,efd->td', h * gates[:, :, None].astype(h.dtype), w_down)
    return y.reshape(B, S, D)


def setup_inputs(seed: int = 0) -> dict:
    key = jax.random.key(seed)
    ks = iter(jax.random.split(key, 40))

    def nrm(shape, scale):
        return jax.random.normal(next(ks), shape, jnp.float32) * scale

    d_s = D_MODEL ** -0.5
    x = nrm((BATCH, SEQ, D_MODEL), 1.0)
    mem = nrm((BATCH, MEM_LEN, D_MODEL), 1.0)
    a_w_in = jnp.concatenate([
        nrm((N_A_LAYERS, D_MODEL, SEQ_MIX_W), d_s),
        nrm((N_A_LAYERS, D_MODEL, SEQ_MIX_W), d_s),
        nrm((N_A_LAYERS, D_MODEL, SEQ_MIX_W), d_s * DEEPNORM_BETA),
        nrm((N_A_LAYERS, D_MODEL, SEQ_MIX_W), d_s),
        nrm((N_A_LAYERS, D_MODEL, MEM_W), d_s),
    ], axis=-1)
    a_lower_bounds = nrm((N_A_LAYERS, SEQ_MIX_W), 0.1)
    a_gnorm = 1.0 + nrm((N_A_LAYERS, SEQ_MIX_W), 0.02)
    b_w_in = nrm((N_B_LAYERS, D_MODEL, B_IN_W), d_s)
    w_kv_shared = jnp.concatenate([nrm((D_MODEL, SEQ_MIX_W), d_s),
                                   nrm((D_MODEL, SEQ_MIX_W), d_s * DEEPNORM_BETA)], axis=-1)
    w_mem_kv = jnp.concatenate([nrm((DEPTH, D_MODEL, MEM_W), d_s),
                                nrm((DEPTH, D_MODEL, MEM_W), d_s * DEEPNORM_BETA)], axis=-1)
    w_o = nrm((DEPTH, MIX_W, D_MODEL), MIX_W ** -0.5 * DEEPNORM_BETA)
    ln_mix_g = 1.0 + nrm((DEPTH, D_MODEL), 0.02)
    ln_mix_b = nrm((DEPTH, D_MODEL), 0.02)
    ln_ffn_g = 1.0 + nrm((DEPTH, D_MODEL), 0.02)
    ln_ffn_b = nrm((DEPTH, D_MODEL), 0.02)
    w_group = nrm((DEPTH, D_MODEL, N_GROUPS), d_s)
    b_group = nrm((DEPTH, N_GROUPS), 0.01)
    w_router = nrm((DEPTH, D_MODEL, N_EXPERTS), d_s)
    b_router = nrm((DEPTH, N_EXPERTS), 0.01)
    w_gate = nrm((DEPTH, N_EXPERTS, D_MODEL, D_EXPERT), d_s)
    w_up = nrm((DEPTH, N_EXPERTS, D_MODEL, D_EXPERT), d_s)
    w_down = nrm((DEPTH, N_EXPERTS, D_EXPERT, D_MODEL), D_EXPERT ** -0.5 * DEEPNORM_BETA)
    return {"x": x, "mem": mem, "a_w_in": a_w_in, "a_lower_bounds": a_lower_bounds,
            "a_gnorm": a_gnorm, "b_w_in": b_w_in, "w_kv_shared": w_kv_shared,
            "w_mem_kv": w_mem_kv, "w_o": w_o, "ln_mix_g": ln_mix_g, "ln_mix_b": ln_mix_b,
            "ln_ffn_g": ln_ffn_g, "ln_ffn_b": ln_ffn_b, "w_group": w_group, "b_group": b_group,
            "w_router": w_router, "b_router": b_router, "w_gate": w_gate, "w_up": w_up,
            "w_down": w_down}


def reference(x, mem, a_w_in, a_lower_bounds, a_gnorm, b_w_in, w_kv_shared, w_mem_kv, w_o,
              ln_mix_g, ln_mix_b, ln_ffn_g, ln_ffn_b, w_group, b_group, w_router, b_router,
              w_gate, w_up, w_down):
    B, S, _ = x.shape
    lb_all = jnp.cumsum(jax.nn.softmax(a_lower_bounds.astype(jnp.float32), axis=0), axis=0)
    lb_all = lb_all - lb_all[0]
    shared_k = None
    shared_v = None
    for layer in range(DEPTH):
        mem_kv = mem @ w_mem_kv[layer]
        mem_k = mem_kv[..., :MEM_W].reshape(B, MEM_LEN, MEM_HEADS, MEM_HEAD_DIM)
        mem_v = mem_kv[..., MEM_W:].reshape(B, MEM_LEN, MEM_HEADS, MEM_HEAD_DIM)
        if layer < N_A_LAYERS:
            h = x @ a_w_in[layer]
            q, f_raw, i_in, g, qm = jnp.split(
                h, [SEQ_MIX_W, 2 * SEQ_MIX_W, 3 * SEQ_MIX_W, 4 * SEQ_MIX_W], axis=-1)
            seq_out = hgrn2_mix(q, f_raw, i_in, g, lb_all[layer], a_gnorm[layer])
        else:
            if layer == N_A_LAYERS:
                kv = x @ w_kv_shared
                shared_k = kv[..., :SEQ_MIX_W].astype(jnp.float32).reshape(
                    B, S, SB_HEADS, SB_HEAD_DIM).transpose(0, 2, 1, 3)
                shared_v = kv[..., SEQ_MIX_W:].astype(jnp.float32).reshape(
                    B, S, SB_HEADS, SB_HEAD_DIM).transpose(0, 2, 1, 3)
            h = x @ b_w_in[layer - N_A_LAYERS]
            q, qm = jnp.split(h, [SEQ_MIX_W], axis=-1)
            seq_out = stick_breaking_attention(q, shared_k, shared_v)
        mem_out = memory_attention(qm, mem_k, mem_v)
        mixed = jnp.concatenate([seq_out.astype(x.dtype), mem_out.astype(x.dtype)], axis=-1)
        x = post_norm(x, mixed @ w_o[layer], ln_mix_g[layer], ln_mix_b[layer])
        moe_out = hier_moe(x, w_group[layer], b_group[layer], w_router[layer], b_router[layer],
                           w_gate[layer], w_up[layer], w_down[layer])
        x = post_norm(x, moe_out, ln_ffn_g[layer], ln_ffn_b[layer])
    return x
```

```cpp
#include <hip/hip_runtime.h>
#include <cstdio>
#include <cstdint>

namespace nv {
constexpr int D = 1024, S = 2048, NB = 8, DEPTH = 4, MEM = 256;
constexpr int SMW = 768, MEMW = 256, AIN = 3328, BIN = 1024, NE = 16, DE = 256;
constexpr float ALPHA = 1.6817928305074290f;
constexpr float LN_EPS = 1e-5f, RMS_EPS = 1e-6f;

template <bool ACC>
__global__ void __launch_bounds__(256) k_gemm(const float* __restrict__ A, int lda, const float* __restrict__ W, int ldw,
                                              float* C, int ldc, int K, const int* idxA, const int* idxC, const int* cntp, int M,
                                              size_t zA, size_t zW, size_t zC, const int* zoff) {
    __shared__ float As[16][68];
    __shared__ float Ws[16][68];
    const int z = blockIdx.z;
    A += (size_t)z * zA; W += (size_t)z * zW; C += (size_t)z * zC;
    int cnt = M;
    if (zoff) { const int o = zoff[z]; cnt = cntp[z]; if (idxA) idxA += o; else A += (size_t)o * lda; if (idxC) idxC += o; else C += (size_t)o * ldc; }
    const int m0 = blockIdx.y * 64, n0 = blockIdx.x * 64;
    if (m0 >= cnt) return;
    const int tx = threadIdx.x & 15, ty = threadIdx.x >> 4;
    float acc[4][4];
#pragma unroll
    for (int i = 0; i < 4; ++i)
#pragma unroll
        for (int j = 0; j < 4; ++j) acc[i][j] = 0.f;
    for (int k0 = 0; k0 < K; k0 += 16) {
#pragma unroll
        for (int i = 0; i < 4; ++i) {
            const int id = threadIdx.x + i * 256, m = id >> 4, k = id & 15;
            float v = 0.f;
            if (m0 + m < cnt) { const int r = idxA ? idxA[m0 + m] : (m0 + m); v = A[(size_t)r * lda + k0 + k]; }
            As[k][m] = v;
        }
#pragma unroll
        for (int i = 0; i < 4; ++i) {
            const int id = threadIdx.x + i * 256, k = id >> 6, n = id & 63;
            Ws[k][n] = W[(size_t)(k0 + k) * ldw + n0 + n];
        }
        __syncthreads();
#pragma unroll
        for (int k = 0; k < 16; ++k) {
            float a[4], w[4];
#pragma unroll
            for (int i = 0; i < 4; ++i) a[i] = As[k][ty * 4 + i];
#pragma unroll
            for (int j = 0; j < 4; ++j) w[j] = Ws[k][tx * 4 + j];
#pragma unroll
            for (int i = 0; i < 4; ++i)
#pragma unroll
                for (int j = 0; j < 4; ++j) acc[i][j] += a[i] * w[j];
        }
        __syncthreads();
    }
#pragma unroll
    for (int i = 0; i < 4; ++i) {
        const int m = m0 + ty * 4 + i;
        if (m < cnt) {
            const int r = idxC ? idxC[m] : m;
#pragma unroll
            for (int j = 0; j < 4; ++j) {
                float* p = C + (size_t)r * ldc + n0 + tx * 4 + j;
                if (ACC) atomicAdd(p, acc[i][j]); else *p = acc[i][j];
            }
        }
    }
}

__global__ void k_lb(const float* alb, float* lb) {
    const int c = blockIdx.x * blockDim.x + threadIdx.x;
    if (c < SMW) {
        const float a0 = alb[c], a1 = alb[SMW + c], m = fmaxf(a0, a1);
        const float e0 = expf(a0 - m), e1 = expf(a1 - m);
        lb[c] = 0.f; lb[SMW + c] = e1 / (e0 + e1);
    }
}

__device__ __forceinline__ float siluf(float x) { return x / (1.f + expf(-x)); }

__global__ void __launch_bounds__(128) k_hgrn(const float* __restrict__ h, const float* __restrict__ lb, float* oraw) {
    __shared__ float red[2][8];
    const int d = threadIdx.x, bb = blockIdx.x / 96, hh = (blockIdx.x % 96) >> 4, et = blockIdx.x & 15;
    h += (size_t)bb * S * AIN; oraw += (size_t)bb * S * SMW;
    const float lbv = lb[hh * 128 + d];
    float Sv[8];
#pragma unroll
    for (int j = 0; j < 8; ++j) Sv[j] = 0.f;
    for (int t = 0; t < S; ++t) {
        const float* row = h + (size_t)t * AIN;
        const float q = siluf(row[hh * 128 + d]) * 0.08838834764831845f;
        const float fr = row[SMW + hh * 128 + d];
        const float f = lbv + (1.f - lbv) / (1.f + expf(-fr));
        const float k = 1.f - f;
        float p[8];
#pragma unroll
        for (int j = 0; j < 8; ++j) { const float v = row[2 * SMW + hh * 128 + et * 8 + j]; Sv[j] = f * Sv[j] + k * v; p[j] = q * Sv[j]; }
#pragma unroll
        for (int o = 32; o >= 1; o >>= 1)
#pragma unroll
            for (int j = 0; j < 8; ++j) p[j] += __shfl_xor(p[j], o);
        if ((d & 63) == 0) {
#pragma unroll
            for (int j = 0; j < 8; ++j) red[d >> 6][j] = p[j];
        }
        __syncthreads();
        if (d < 8) oraw[(size_t)t * SMW + hh * 128 + et * 8 + d] = red[0][d] + red[1][d];
        __syncthreads();
    }
}

__global__ void __launch_bounds__(128) k_hgrn_post(const float* oraw, const float* h, const float* gnorm, float* mixed) {
    __shared__ float red[2];
    const int e = threadIdx.x, t = blockIdx.x / 6, hh = blockIdx.x % 6;
    const float o = oraw[(size_t)t * SMW + hh * 128 + e];
    float s = o * o;
#pragma unroll
    for (int off = 32; off >= 1; off >>= 1) s += __shfl_xor(s, off);
    if ((e & 63) == 0) red[e >> 6] = s;
    __syncthreads();
    const float ms = (red[0] + red[1]) * (1.f / 128.f);
    const float g = h[(size_t)t * AIN + 3 * SMW + hh * 128 + e];
    mixed[(size_t)t * D + hh * 128 + e] = o * rsqrtf(ms + RMS_EPS) * gnorm[hh * 128 + e] * siluf(g);
}

__global__ void __launch_bounds__(64) k_sb(const float* __restrict__ hq, int ldq, const float* __restrict__ kv, float* mixed) {
    const int t = blockIdx.x * 64 + threadIdx.x, hh = blockIdx.y, bb = blockIdx.z;
    hq += (size_t)bb * S * ldq; kv += (size_t)bb * S * 1536; mixed += (size_t)bb * S * D;
    float q[64], o[64];
#pragma unroll
    for (int d = 0; d < 64; ++d) { q[d] = hq[(size_t)t * ldq + hh * 64 + d] * 0.125f; o[d] = 0.f; }
    float rest = 0.f;
    for (int s = t - 1; s >= 0; --s) {
        const float* kr = kv + (size_t)s * 1536 + hh * 64;
        float z = 0.f;
#pragma unroll
        for (int d = 0; d < 64; ++d) z += q[d] * kr[d];
        const float sp = (z > 0.f ? z : 0.f) + log1pf(expf(-fabsf(z)));
        const float a = expf(z - sp - rest);
        const float* vr = kr + SMW;
#pragma unroll
        for (int d = 0; d < 64; ++d) o[d] += a * vr[d];
        rest += sp;
    }
#pragma unroll
    for (int d = 0; d < 64; ++d) mixed[(size_t)t * D + hh * 64 + d] = o[d];
}

__global__ void __launch_bounds__(64) k_memattn(const float* __restrict__ hq, int ldq, int qoff, const float* __restrict__ mkv, int b0, float* mixed) {
    const int t = blockIdx.x * 64 + threadIdx.x, hm = blockIdx.y, bb = blockIdx.z;
    hq += (size_t)bb * S * ldq; mixed += (size_t)bb * S * D; mkv += (size_t)(b0 + bb) * MEM * 512;
    float q[64], o[64];
#pragma unroll
    for (int d = 0; d < 64; ++d) { q[d] = hq[(size_t)t * ldq + qoff + hm * 64 + d] * 0.125f; o[d] = 0.f; }
    float mx = -INFINITY;
    for (int m = 0; m < MEM; ++m) {
        const float* kr = mkv + (size_t)m * 512 + hm * 64;
        float z = 0.f;
#pragma unroll
        for (int d = 0; d < 64; ++d) z += q[d] * kr[d];
        mx = fmaxf(mx, z);
    }
    float l = 0.f;
    for (int m = 0; m < MEM; ++m) {
        const float* kr = mkv + (size_t)m * 512 + hm * 64;
        float z = 0.f;
#pragma unroll
        for (int d = 0; d < 64; ++d) z += q[d] * kr[d];
        const float p = expf(z - mx);
        l += p;
        const float* vr = kr + 256;
#pragma unroll
        for (int d = 0; d < 64; ++d) o[d] += p * vr[d];
    }
    const float rl = 1.f / l;
#pragma unroll
    for (int d = 0; d < 64; ++d) mixed[(size_t)t * D + SMW + hm * 64 + d] = o[d] * rl;
}

__global__ void __launch_bounds__(256) k_postnorm(float* x, const float* y, const float* g, const float* b) {
    __shared__ float red[4];
    const int t = blockIdx.x, tid = threadIdx.x;
    float v[4]; float s = 0.f;
#pragma unroll
    for (int i = 0; i < 4; ++i) { const int c = tid + 256 * i; v[i] = ALPHA * x[(size_t)t * D + c] + y[(size_t)t * D + c]; s += v[i]; }
#pragma unroll
    for (int off = 32; off >= 1; off >>= 1) s += __shfl_xor(s, off);
    if ((tid & 63) == 0) red[tid >> 6] = s;
    __syncthreads();
    const float mean = (red[0] + red[1] + red[2] + red[3]) * (1.f / D);
    __syncthreads();
    float s2 = 0.f;
#pragma unroll
    for (int i = 0; i < 4; ++i) { v[i] -= mean; s2 += v[i] * v[i]; }
#pragma unroll
    for (int off = 32; off >= 1; off >>= 1) s2 += __shfl_xor(s2, off);
    if ((tid & 63) == 0) red[tid >> 6] = s2;
    __syncthreads();
    const float rstd = rsqrtf((red[0] + red[1] + red[2] + red[3]) * (1.f / D) + LN_EPS);
#pragma unroll
    for (int i = 0; i < 4; ++i) { const int c = tid + 256 * i; x[(size_t)t * D + c] = v[i] * rstd * g[c] + b[c]; }
}

__global__ void __launch_bounds__(64) k_router(const float* __restrict__ x, const float* __restrict__ wg, const float* __restrict__ bg,
                                               const float* __restrict__ wr, const float* __restrict__ br, float* gates, float* y) {
    const int t = blockIdx.x, lane = threadIdx.x;
    float acc[20];
#pragma unroll
    for (int j = 0; j < 20; ++j) acc[j] = 0.f;
    for (int i = 0; i < 16; ++i) {
        const int k = lane + 64 * i; const float xv = x[(size_t)t * D + k];
        y[(size_t)t * D + k] = 0.f;
#pragma unroll
        for (int j = 0; j < 4; ++j) acc[j] += xv * wg[k * 4 + j];
#pragma unroll
        for (int j = 0; j < 16; ++j) acc[4 + j] += xv * wr[k * 16 + j];
    }
#pragma unroll
    for (int off = 32; off >= 1; off >>= 1)
#pragma unroll
        for (int j = 0; j < 20; ++j) acc[j] += __shfl_xor(acc[j], off);
    if (lane == 0) {
        float lg[4]; float mx = -INFINITY; int gi = 0;
#pragma unroll
        for (int j = 0; j < 4; ++j) { lg[j] = acc[j] + bg[j]; if (lg[j] > mx) { mx = lg[j]; gi = j; } }
        float sg = 0.f;
#pragma unroll
        for (int j = 0; j < 4; ++j) sg += expf(lg[j] - mx);
        const float ptop = 1.f / sg;
        float le[4];
#pragma unroll
        for (int j = 0; j < 4; ++j) { float v = 0.f;
#pragma unroll
            for (int g2 = 0; g2 < 4; ++g2) v = (g2 == gi) ? (acc[4 + g2 * 4 + j] + br[g2 * 4 + j]) : v;
            le[j] = v; }
        int i0 = 0; float m0 = le[0];
#pragma unroll
        for (int j = 1; j < 4; ++j) if (le[j] > m0) { m0 = le[j]; i0 = j; }
        int i1 = 0; float m1 = -INFINITY;
#pragma unroll
        for (int j = 0; j < 4; ++j) if (j != i0 && le[j] > m1) { m1 = le[j]; i1 = j; }
        const float e1 = expf(m1 - m0);
        const float w0 = 1.f / (1.f + e1), w1 = e1 / (1.f + e1);
#pragma unroll
        for (int j = 0; j < 16; ++j) gates[(size_t)t * 16 + j] = 0.f;
        gates[(size_t)t * 16 + gi * 4 + i0] = ptop * w0;
        gates[(size_t)t * 16 + gi * 4 + i1] = ptop * w1;
    }
}

__global__ void __launch_bounds__(1024) k_compact(const float* gates, int* idx, int* cnt, int* off, int* rowexp, int nrows) {
    __shared__ int c_s[NE], o_s[NE];
    const int e = threadIdx.x >> 6, lane = threadIdx.x & 63;
    int n = 0;
    for (int c = 0; c < nrows; c += 64) n += __popcll(__ballot(gates[(size_t)(c + lane) * 16 + e] != 0.f));
    if (lane == 0) { c_s[e] = n; cnt[e] = n; }
    __syncthreads();
    if (threadIdx.x == 0) { int a = 0; for (int j = 0; j < NE; ++j) { o_s[j] = a; off[j] = a; a += c_s[j]; } }
    __syncthreads();
    int base = o_s[e];
    for (int c = 0; c < nrows; c += 64) {
        const bool f = gates[(size_t)(c + lane) * 16 + e] != 0.f;
        const unsigned long long m = __ballot(f);
        if (f) { const int p = base + __popcll(m & ((1ull << lane) - 1ull)); idx[p] = c + lane; rowexp[p] = e; }
        base += __popcll(m);
    }
}
__global__ void __launch_bounds__(256) k_hmul(float* G, const float* U, const float* gates, const int* idx, const int* rowexp) {
    const int r = blockIdx.x, f = threadIdx.x;
    const int t = idx[r], e = rowexp[r];
    G[(size_t)r * DE + f] = siluf(G[(size_t)r * DE + f]) * U[(size_t)r * DE + f] * gates[(size_t)t * 16 + e];
}
}

extern "C" void kernel_launch(void* const* d_in, const int* in_sizes, int n_in, void* d_out, int out_size, void* d_ws, size_t ws_size, hipStream_t stream) {
    using namespace nv;
    const float* x = (const float*)d_in[0];        const float* mem = (const float*)d_in[1];
    const float* a_w_in = (const float*)d_in[2];   const float* a_lb = (const float*)d_in[3];
    const float* a_gn = (const float*)d_in[4];     const float* b_w_in = (const float*)d_in[5];
    const float* w_kv = (const float*)d_in[6];     const float* w_memkv = (const float*)d_in[7];
    const float* w_o = (const float*)d_in[8];      const float* lnm_g = (const float*)d_in[9];
    const float* lnm_b = (const float*)d_in[10];   const float* lnf_g = (const float*)d_in[11];
    const float* lnf_b = (const float*)d_in[12];   const float* w_group = (const float*)d_in[13];
    const float* b_group = (const float*)d_in[14]; const float* w_router = (const float*)d_in[15];
    const float* b_router = (const float*)d_in[16]; const float* w_gate = (const float*)d_in[17];
    const float* w_up = (const float*)d_in[18];    const float* w_down = (const float*)d_in[19];
    float* out = (float*)d_out;
    constexpr int HB = 4, R = HB * S;
    char* ws = (char*)d_ws; size_t off = 0;
    auto carve = [&](size_t bytes) { void* p = ws + off; off += (bytes + 255) & ~(size_t)255; return p; };
    float* H = (float*)carve((size_t)R * AIN * 4);
    float* KV = (float*)carve((size_t)R * 1536 * 4);
    float* MKV = (float*)carve((size_t)DEPTH * NB * MEM * 512 * 4);
    float* MIX = (float*)carve((size_t)R * D * 4);
    float* ORAW = (float*)carve((size_t)R * SMW * 4);
    float* Y = (float*)carve((size_t)R * D * 4);
    float* GATES = (float*)carve((size_t)R * 16 * 4);
    float* GU = (float*)carve((size_t)2 * 2 * R * DE * 4);
    float* LB = (float*)carve(2 * SMW * 4);
    int* IDX = (int*)carve((size_t)2 * R * 4);
    int* REXP = (int*)carve((size_t)2 * R * 4);
    int* CNT = (int*)carve(64 * 4);
    int* OFF = (int*)carve(64 * 4);
    if (off > ws_size) { fprintf(stderr, "ws too small: need %zu have %zu\n", off, ws_size); return; }
    const size_t GUZ = (size_t)2 * R * DE;

    k_lb<<<3, 256, 0, stream>>>(a_lb, LB);
    (void)hipMemcpyAsync(out, x, (size_t)NB * S * D * 4, hipMemcpyDeviceToDevice, stream);
    k_gemm<false><<<dim3(512 / 64, NB * MEM / 64, DEPTH), 256, 0, stream>>>(mem, D, w_memkv, 512, MKV, 512, D, nullptr, nullptr, nullptr, NB * MEM,
                                                                            0, (size_t)D * 512, (size_t)NB * MEM * 512, nullptr);
    for (int hf = 0; hf < NB / HB; ++hf) {
        float* xb = out + (size_t)hf * R * D;
        for (int l = 0; l < DEPTH; ++l) {
            const float* mkv_l = MKV + (size_t)l * NB * MEM * 512;
            if (l < 2) {
                k_gemm<false><<<dim3(AIN / 64, R / 64, 1), 256, 0, stream>>>(xb, D, a_w_in + (size_t)l * D * AIN, AIN, H, AIN, D, nullptr, nullptr, nullptr, R, 0, 0, 0, nullptr);
                k_hgrn<<<HB * 96, 128, 0, stream>>>(H, LB + l * SMW, ORAW);
                k_hgrn_post<<<R * 6, 128, 0, stream>>>(ORAW, H, a_gn + l * SMW, MIX);
                k_memattn<<<dim3(S / 64, 4, HB), 64, 0, stream>>>(H, AIN, 4 * SMW, mkv_l, hf * HB, MIX);
            } else {
                if (l == 2) k_gemm<false><<<dim3(1536 / 64, R / 64, 1), 256, 0, stream>>>(xb, D, w_kv, 1536, KV, 1536, D, nullptr, nullptr, nullptr, R, 0, 0, 0, nullptr);
                k_gemm<false><<<dim3(BIN / 64, R / 64, 1), 256, 0, stream>>>(xb, D, b_w_in + (size_t)(l - 2) * D * BIN, BIN, H, BIN, D, nullptr, nullptr, nullptr, R, 0, 0, 0, nullptr);
                k_sb<<<dim3(S / 64, 12, HB), 64, 0, stream>>>(H, BIN, KV, MIX);
                k_memattn<<<dim3(S / 64, 4, HB), 64, 0, stream>>>(H, BIN, SMW, mkv_l, hf * HB, MIX);
            }
            k_gemm<false><<<dim3(D / 64, R / 64, 1), 256, 0, stream>>>(MIX, D, w_o + (size_t)l * D * D, D, Y, D, D, nullptr, nullptr, nullptr, R, 0, 0, 0, nullptr);
            k_postnorm<<<R, 256, 0, stream>>>(xb, Y, lnm_g + l * D, lnm_b + l * D);
            k_router<<<R, 64, 0, stream>>>(xb, w_group + (size_t)l * D * 4, b_group + l * 4, w_router + (size_t)l * D * 16, b_router + l * 16, GATES, Y);
            k_compact<<<1, 1024, 0, stream>>>(GATES, IDX, CNT, OFF, REXP, R);
            k_gemm<false><<<dim3(DE / 64, R / 64, NE), 256, 0, stream>>>(xb, D, w_gate + (size_t)l * NE * D * DE, DE, GU, DE, D, IDX, nullptr, CNT, R, 0, (size_t)D * DE, 0, OFF);
            k_gemm<false><<<dim3(DE / 64, R / 64, NE), 256, 0, stream>>>(xb, D, w_up + (size_t)l * NE * D * DE, DE, GU + GUZ, DE, D, IDX, nullptr, CNT, R, 0, (size_t)D * DE, 0, OFF);
            k_hmul<<<2 * R, 256, 0, stream>>>(GU, GU + GUZ, GATES, IDX, REXP);
            k_gemm<true><<<dim3(D / 64, R / 64, NE), 256, 0, stream>>>(GU, DE, w_down + (size_t)l * NE * DE * D, D, Y, D, DE, nullptr, IDX, CNT, R, 0, (size_t)DE * D, 0, OFF);
            k_postnorm<<<R, 256, 0, stream>>>(xb, Y, lnf_g + l * D, lnf_b + l * D);
        }
    }
}
```
